# Optimizing an MI355X kernel written in HIP

```python
import math
import jax, jax.numpy as jnp
from jax import lax
import numpy as np

D_MODEL = 1024
BATCH = 8
SEQ = 4096
DEPTH = 1

D_MIX = D_MODEL
D_FF = 2816
SGU_WIDTH = D_MIX // 2
SGU_GROUPS = 4
SGU_GROUP_DIM = SGU_WIDTH // SGU_GROUPS
CHUNK = 128
DIFF_WIDTH = D_MIX - SGU_WIDTH
DIFF_HEAD_DIM = 64
DIFF_HEADS = DIFF_WIDTH // (2 * DIFF_HEAD_DIM)
Q_BLOCK = 128
ROPE_THETA = 10000.0
RMS_EPS = 1e-6
SUBLN_EPS = 1e-5
LN_EPS = 1e-5
NEG_INF = -1e30

IN_COLS = 2 * SGU_WIDTH + 3 * DIFF_WIDTH
SPLITS = (SGU_WIDTH, 2 * SGU_WIDTH, 2 * SGU_WIDTH + DIFF_WIDTH, 2 * SGU_WIDTH + 2 * DIFF_WIDTH)

kernel_name = "hymba_sgu_diffattn_macaron"


def _rms(x, g, eps=RMS_EPS):
    xf = x.astype(jnp.float32)
    y = xf * lax.rsqrt(jnp.mean(xf * xf, axis=-1, keepdims=True) + eps)
    return (y * g.astype(jnp.float32)).astype(x.dtype)


def _layernorm(x, g, b, eps=LN_EPS):
    xf = x.astype(jnp.float32)
    mu = jnp.mean(xf, axis=-1, keepdims=True)
    var = jnp.mean(jnp.square(xf - mu), axis=-1, keepdims=True)
    y = (xf - mu) * lax.rsqrt(var + eps)
    return (y * g.astype(jnp.float32) + b.astype(jnp.float32)).astype(x.dtype)


def _swiglu(h, w_gate, w_up, w_down):
    return (jax.nn.silu(h @ w_gate) * (h @ w_up)) @ w_down


def _rope_tables(seq):
    half = DIFF_HEAD_DIM // 2
    inv_freq = 1.0 / (ROPE_THETA ** (jnp.arange(half, dtype=jnp.float32) / half))
    ang = jnp.arange(seq, dtype=jnp.float32)[:, None] * inv_freq[None, :]
    return jnp.cos(ang), jnp.sin(ang)


def _rotary(t, cos, sin):
    half = DIFF_HEAD_DIM // 2
    c = cos[:, None, None, :].astype(t.dtype)
    s = sin[:, None, None, :].astype(t.dtype)
    t1, t2 = t[..., :half], t[..., half:]
    return jnp.concatenate([t1 * c - t2 * s, t2 * c + t1 * s], axis=-1)


def _chunked_sgu(u, v, ln_g, ln_b, w_s, b_s):
    bsz, seq, _ = v.shape
    n_chunks = seq // CHUNK
    v = _layernorm(v, ln_g, ln_b).reshape(bsz, n_chunks, CHUNK, SGU_GROUPS, SGU_GROUP_DIM)
    causal = jnp.tril(jnp.ones((CHUNK, CHUNK), dtype=bool))
    w = jnp.where(causal, w_s, jnp.zeros_like(w_s))
    mixed = jnp.einsum('gts,bcsgd->bctgd', w, v) + b_s.T[None, None, :, :, None]
    return u * mixed.reshape(bsz, seq, SGU_WIDTH)


def _diff_attention(q, k, v, lam):
    bsz, seq = q.shape[0], q.shape[1]
    n_blocks = seq // Q_BLOCK
    scale = DIFF_HEAD_DIM ** -0.5
    kpos = jnp.arange(seq)

    def block(i):
        start = i * Q_BLOCK
        qb = lax.dynamic_slice_in_dim(q, start, Q_BLOCK, axis=1)
        s = jnp.einsum('bqhcd,bkhcd->bhcqk', qb, k).astype(jnp.float32) * scale
        qpos = start + jnp.arange(Q_BLOCK)
        s = jnp.where(qpos[:, None] >= kpos[None, :], s, NEG_INF)
        p = jax.nn.softmax(s, axis=-1)
        a = p[:, :, 0] - lam * p[:, :, 1]
        return jnp.einsum('bhqk,bkhe->bqhe', a.astype(v.dtype), v)

    out = lax.map(block, jnp.arange(n_blocks))
    return out.transpose(1, 0, 2, 3, 4).reshape(bsz, seq, DIFF_HEADS, 2 * DIFF_HEAD_DIM)


def setup_inputs(seed: int = 0) -> dict:
    key = jax.random.key(seed)
    ks = jax.random.split(key, 32)

    def nrm(k, shape, scale):
        return jax.random.normal(k, shape, dtype=jnp.float32) * scale

    def gain(k, shape):
        return 1.0 + 0.02 * jax.random.normal(k, shape, dtype=jnp.float32)

    L = DEPTH
    return {
        "x": nrm(ks[0], (BATCH, SEQ, D_MODEL), 1.0),
        "ffn1_pre_g": gain(ks[1], (L, D_MODEL)),
        "ffn1_w_gate": nrm(ks[2], (L, D_MODEL, D_FF), D_MODEL ** -0.5),
        "ffn1_w_up": nrm(ks[3], (L, D_MODEL, D_FF), D_MODEL ** -0.5),
        "ffn1_w_down": nrm(ks[4], (L, D_FF, D_MODEL), D_FF ** -0.5),
        "ffn1_post_g": gain(ks[5], (L, D_MODEL)),
        "mix_pre_g": gain(ks[6], (L, D_MODEL)),
        "w_in": nrm(ks[7], (L, D_MODEL, IN_COLS), D_MODEL ** -0.5),
        "sgu_ln_g": gain(ks[8], (L, SGU_WIDTH)),
        "sgu_ln_b": nrm(ks[9], (L, SGU_WIDTH), 0.02),
        "sgu_w_s": nrm(ks[10], (L, SGU_GROUPS, CHUNK, CHUNK), CHUNK ** -0.5),
        "sgu_b_s": gain(ks[11], (L, SGU_GROUPS, CHUNK)),
        "lambda_q1": nrm(ks[12], (L, DIFF_HEAD_DIM), 0.1),
        "lambda_k1": nrm(ks[13], (L, DIFF_HEAD_DIM), 0.1),
        "lambda_q2": nrm(ks[14], (L, DIFF_HEAD_DIM), 0.1),
        "lambda_k2": nrm(ks[15], (L, DIFF_HEAD_DIM), 0.1),
        "diff_subln_g": gain(ks[16], (L, 2 * DIFF_HEAD_DIM)),
        "w_out": nrm(ks[17], (L, D_MIX, D_MODEL), D_MIX ** -0.5),
        "mix_post_g": gain(ks[18], (L, D_MODEL)),
        "ffn2_pre_g": gain(ks[19], (L, D_MODEL)),
        "ffn2_w_gate": nrm(ks[20], (L, D_MODEL, D_FF), D_MODEL ** -0.5),
        "ffn2_w_up": nrm(ks[21], (L, D_MODEL, D_FF), D_MODEL ** -0.5),
        "ffn2_w_down": nrm(ks[22], (L, D_FF, D_MODEL), D_FF ** -0.5),
        "ffn2_post_g": gain(ks[23], (L, D_MODEL)),
    }


def reference(x, ffn1_pre_g, ffn1_w_gate, ffn1_w_up, ffn1_w_down, ffn1_post_g,
              mix_pre_g, w_in, sgu_ln_g, sgu_ln_b, sgu_w_s, sgu_b_s,
              lambda_q1, lambda_k1, lambda_q2, lambda_k2, diff_subln_g, w_out, mix_post_g,
              ffn2_pre_g, ffn2_w_gate, ffn2_w_up, ffn2_w_down, ffn2_post_g):
    bsz, seq, _ = x.shape
    cos, sin = _rope_tables(seq)
    for l in range(DEPTH):
        lambda_init = 0.8 - 0.6 * math.exp(-0.3 * l)

        h = _swiglu(_rms(x, ffn1_pre_g[l]), ffn1_w_gate[l], ffn1_w_up[l], ffn1_w_down[l])
        x = x + 0.5 * _rms(h, ffn1_post_g[l])

        h = _rms(x, mix_pre_g[l])
        z = h @ w_in[l]
        za_u, za_v, zq, zk, zv = jnp.split(z, SPLITS, axis=-1)

        a_out = _chunked_sgu(jax.nn.gelu(za_u), jax.nn.gelu(za_v),
                             sgu_ln_g[l], sgu_ln_b[l], sgu_w_s[l], sgu_b_s[l])

        q = _rotary(zq.reshape(bsz, seq, DIFF_HEADS, 2, DIFF_HEAD_DIM), cos, sin)
        k = _rotary(zk.reshape(bsz, seq, DIFF_HEADS, 2, DIFF_HEAD_DIM), cos, sin)
        v = zv.reshape(bsz, seq, DIFF_HEADS, 2 * DIFF_HEAD_DIM)
        lam = (jnp.exp(jnp.sum(lambda_q1[l].astype(jnp.float32) * lambda_k1[l].astype(jnp.float32)))
               - jnp.exp(jnp.sum(lambda_q2[l].astype(jnp.float32) * lambda_k2[l].astype(jnp.float32)))
               + lambda_init)
        o = _diff_attention(q, k, v, lam)
        o = _rms(o, diff_subln_g[l], eps=SUBLN_EPS) * (1.0 - lambda_init)

        mix = jnp.concatenate([a_out, o.reshape(bsz, seq, DIFF_WIDTH)], axis=-1) @ w_out[l]
        x = x + _rms(mix, mix_post_g[l])

        h = _swiglu(_rms(x, ffn2_pre_g[l]), ffn2_w_gate[l], ffn2_w_up[l], ffn2_w_down[l])
        x = x + 0.5 * _rms(h, ffn2_post_g[l])
    return x
```

```cpp
#include <hip/hip_runtime.h>
#include <cstdint>
#include <cstdio>

constexpr int BATCH = 8, SEQ = 4096, DM = 1024, DFF = 2816, M = BATCH * SEQ;
constexpr int SGW = 512, NGRP = 4, GD = 128, CHUNK = 128, DW = 512, HD = 64, NH = 4, INC = 2560;
constexpr float RMS_EPS = 1e-6f, SUBLN_EPS = 1e-5f, LN_EPS = 1e-5f;
constexpr float C2 = 0.125f * 1.4426950408889634f;
constexpr float LAMBDA_INIT = 0.2f;

typedef unsigned short bf16;
__device__ __forceinline__ unsigned f2bf(float f) { unsigned u = __builtin_bit_cast(unsigned, f); return (u + 0x7fffu + ((u >> 16) & 1u)) >> 16; }
__device__ __forceinline__ float bf2f(bf16 b) { return __builtin_bit_cast(float, (unsigned)b << 16); }

constexpr size_t MiB = 1u << 20;
constexpr size_t WS_CTL = 0;
constexpr size_t WS_ROPE = 1 * MiB;
constexpr size_t WS_XN = 64 * MiB;
constexpr size_t WS_ACT = 128 * MiB;
constexpr size_t WS_U = WS_ACT, WS_VS = WS_ACT + 32 * MiB, WS_Q = WS_ACT + 64 * MiB, WS_K = WS_ACT + 96 * MiB, WS_V = WS_ACT + 128 * MiB;
constexpr size_t WS_AMIX = 304 * MiB;
constexpr size_t WS_STASH = 368 * MiB;
constexpr size_t WS_END = 496 * MiB;

__device__ __forceinline__ float wave_sum(float v) {
#pragma unroll
    for (int o = 1; o < 64; o <<= 1) v += __shfl_xor(v, o);
    return v;
}
__device__ __forceinline__ float gelu_tanh(float x) {
    const float y = 0.7978845608028654f * (x + 0.044715f * x * x * x);
    const float t = 1.0f - 2.0f / (__expf(2.0f * y) + 1.0f);
    return 0.5f * x * (1.0f + t);
}

__global__ void k_rope_table(float* cs) {
    const int i = blockIdx.x * blockDim.x + threadIdx.x;
    if (i >= SEQ * 32) return;
    const int pos = i >> 5, j = i & 31;
    const float inv_freq = (float)(1.0 / pow(10000.0, (double)j / 32.0));
    const float ang = (float)pos * inv_freq;
    double a = (double)ang;
    const double TWO_PI = 6.283185307179586476925287;
    a -= TWO_PI * rint(a / TWO_PI);
    const double a2 = a * a;
    double c = 1.0, s = a, tc = 1.0, ts = a;
#pragma unroll 1
    for (int n = 1; n <= 14; ++n) { tc *= -a2 / (double)((2 * n - 1) * (2 * n)); ts *= -a2 / (double)((2 * n) * (2 * n + 1)); c += tc; s += ts; }
    cs[i] = (float)c; cs[SEQ * 32 + i] = (float)s;
}

__global__ __launch_bounds__(256) void k_rms_bf16(const float* x, const float* g, bf16* xn) {
    const int row = blockIdx.x * 4 + (threadIdx.x >> 6), lane = threadIdx.x & 63;
    const float* xr = x + (size_t)row * DM;
    float v[16]; float ss = 0.f;
#pragma unroll
    for (int j = 0; j < 4; ++j) { const float4 t = *(const float4*)(xr + j * 256 + lane * 4); v[4 * j] = t.x; v[4 * j + 1] = t.y; v[4 * j + 2] = t.z; v[4 * j + 3] = t.w; ss += t.x * t.x + t.y * t.y + t.z * t.z + t.w * t.w; }
    const float r = rsqrtf(wave_sum(ss) * (1.f / DM) + RMS_EPS);
#pragma unroll
    for (int j = 0; j < 4; ++j)
#pragma unroll
        for (int e = 0; e < 4; ++e) { const int c = j * 256 + lane * 4 + e; xn[(size_t)row * DM + c] = (bf16)f2bf(v[4 * j + e] * r * g[c]); }
}

__global__ __launch_bounds__(256) void k_rowpost(const float* tmp, const float* base, const float* g1, float* out, const float* g2, bf16* xn, float scale, int pad_) {
    const int row = blockIdx.x * 4 + (threadIdx.x >> 6), lane = threadIdx.x & 63;
    float v[16]; float ss = 0.f;
#pragma unroll
    for (int j = 0; j < 4; ++j) { const float4 t = *(const float4*)(tmp + (size_t)row * DM + j * 256 + lane * 4); v[4 * j] = t.x; v[4 * j + 1] = t.y; v[4 * j + 2] = t.z; v[4 * j + 3] = t.w; ss += t.x * t.x + t.y * t.y + t.z * t.z + t.w * t.w; }
    const float r = rsqrtf(wave_sum(ss) * (1.f / DM) + RMS_EPS);
    float ss2 = 0.f;
#pragma unroll
    for (int j = 0; j < 4; ++j)
#pragma unroll
        for (int e = 0; e < 4; ++e) { const int c = j * 256 + lane * 4 + e; const float o = base[(size_t)row * DM + c] + scale * (v[4 * j + e] * r * g1[c]); v[4 * j + e] = o; ss2 += o * o; }
#pragma unroll
    for (int j = 0; j < 4; ++j) *(float4*)(out + (size_t)row * DM + j * 256 + lane * 4) = make_float4(v[4 * j], v[4 * j + 1], v[4 * j + 2], v[4 * j + 3]);
    if (xn) {
        const float r2 = rsqrtf(wave_sum(ss2) * (1.f / DM) + RMS_EPS);
#pragma unroll
        for (int j = 0; j < 4; ++j)
#pragma unroll
            for (int e = 0; e < 4; ++e) { const int c = j * 256 + lane * 4 + e; xn[(size_t)row * DM + c] = (bf16)f2bf(v[4 * j + e] * r2 * g2[c]); }
    }
}

struct EpiSwiglu { bf16* act; __device__ void operator()(int row, int col, float g, float u) const { act[(size_t)row * DFF + col] = (bf16)f2bf(g / (1.f + __expf(-g)) * u); } };
struct EpiF32 { float* C; int ldc; int pad; __device__ void operator()(int row, int col, float v, float) const { C[(size_t)row * ldc + col] = v; } };
struct EpiWin { bf16 *U, *VS, *V; float* TMP;
    __device__ void operator()(int row, int col, float v, float) const {
        if (col < 512) U[(size_t)row * 512 + col] = (bf16)f2bf(gelu_tanh(v));
        else if (col < 1024) VS[(size_t)row * 512 + col - 512] = (bf16)f2bf(gelu_tanh(v));
        else if (col < 2048) TMP[(size_t)row * 1024 + col - 1024] = v;
        else V[(size_t)row * 512 + col - 2048] = (bf16)f2bf(v);
    } };
template <class Epi, bool DUAL>
__global__ __launch_bounds__(256) void k_gemm_naive(const bf16* A, const float* B0, const float* B1, Epi epi, int lda, int ldb, int K, int pad_) {
    __shared__ float As[16][68], Bs0[16][68], Bs1[DUAL ? 16 : 1][68];
    const int tid = threadIdx.x, tx = tid & 15, ty = tid >> 4;
    const int row0 = blockIdx.y * 64, col0 = blockIdx.x * 64;
    float acc0[4][4] = {}, acc1[4][4] = {};
    for (int k0 = 0; k0 < K; k0 += 16) {
        { const int r = tid >> 2, kk = (tid & 3) * 4; const ushort4 a = *(const ushort4*)(A + (size_t)(row0 + r) * lda + k0 + kk);
          As[kk][r] = bf2f(a.x); As[kk + 1][r] = bf2f(a.y); As[kk + 2][r] = bf2f(a.z); As[kk + 3][r] = bf2f(a.w); }
        { const int kk = tid >> 4, n = (tid & 15) * 4; const float4 b = *(const float4*)(B0 + (size_t)(k0 + kk) * ldb + col0 + n);
          Bs0[kk][n] = b.x; Bs0[kk][n + 1] = b.y; Bs0[kk][n + 2] = b.z; Bs0[kk][n + 3] = b.w;
          if (DUAL) { const float4 c = *(const float4*)(B1 + (size_t)(k0 + kk) * ldb + col0 + n); Bs1[kk][n] = c.x; Bs1[kk][n + 1] = c.y; Bs1[kk][n + 2] = c.z; Bs1[kk][n + 3] = c.w; } }
        __syncthreads();
#pragma unroll
        for (int kk = 0; kk < 16; ++kk) {
            float a[4], b[4], c[4];
#pragma unroll
            for (int i = 0; i < 4; ++i) { a[i] = As[kk][ty * 4 + i]; b[i] = Bs0[kk][tx * 4 + i]; c[i] = DUAL ? Bs1[kk][tx * 4 + i] : 0.f; }
#pragma unroll
            for (int i = 0; i < 4; ++i)
#pragma unroll
                for (int j = 0; j < 4; ++j) { acc0[i][j] += a[i] * b[j]; if (DUAL) acc1[i][j] += a[i] * c[j]; }
        }
        __syncthreads();
    }
#pragma unroll
    for (int i = 0; i < 4; ++i)
#pragma unroll
        for (int j = 0; j < 4; ++j) epi(row0 + ty * 4 + i, col0 + tx * 4 + j, acc0[i][j], acc1[i][j]);
}

__global__ void k_rope_apply(const float* tmp, const float* cs, bf16* Q, bf16* Kb) {
    const size_t i = (size_t)blockIdx.x * blockDim.x + threadIdx.x;
    if (i >= (size_t)M * 16 * 32) return;
    const int j = (int)(i & 31), hc = (int)((i >> 5) & 15); const size_t row = i >> 9;
    const int pos = (int)(row % SEQ);
    const float c = cs[pos * 32 + j], s = cs[SEQ * 32 + pos * 32 + j];
    const float t1 = tmp[row * 1024 + hc * 64 + j], t2 = tmp[row * 1024 + hc * 64 + 32 + j];
    const float o1 = t1 * c - t2 * s, o2 = t2 * c + t1 * s;
    if (hc < 8) { Q[row * 512 + hc * 64 + j] = (bf16)f2bf(o1 * C2); Q[row * 512 + hc * 64 + 32 + j] = (bf16)f2bf(o2 * C2); }
    else { Kb[row * 512 + (hc - 8) * 64 + j] = (bf16)f2bf(o1); Kb[row * 512 + (hc - 8) * 64 + 32 + j] = (bf16)f2bf(o2); }
}

__global__ __launch_bounds__(256) void k_attn_naive(const bf16* Q, const bf16* Kb, const bf16* V, float* O1, float* O2) {
    __shared__ float ks[64][64];
    __shared__ float vs[64][128];
    const int qb = blockIdx.x, hc = blockIdx.y, b = blockIdx.z, h = hc >> 1, c = hc & 1;
    const int t = qb * 256 + threadIdx.x; const size_t row = (size_t)b * SEQ + t;
    float q[64], o[128];
#pragma unroll
    for (int d = 0; d < 64; ++d) q[d] = bf2f(Q[row * 512 + h * 128 + c * 64 + d]);
#pragma unroll
    for (int d = 0; d < 128; ++d) o[d] = 0.f;
    float m = -1e30f, l = 0.f;
    const int nkt = (qb * 256 + 256) / 64;
    for (int kt = 0; kt < nkt; ++kt) {
        __syncthreads();
        for (int e = threadIdx.x; e < 64 * 64; e += 256) { const int j = e >> 6, d = e & 63; ks[j][d] = bf2f(Kb[((size_t)b * SEQ + kt * 64 + j) * 512 + h * 128 + c * 64 + d]); }
        for (int e = threadIdx.x; e < 64 * 128; e += 256) { const int j = e >> 7, d = e & 127; vs[j][d] = bf2f(V[((size_t)b * SEQ + kt * 64 + j) * 512 + h * 128 + d]); }
        __syncthreads();
        for (int j = 0; j < 64; ++j) {
            if (kt * 64 + j > t) break;
            float s = 0.f;
#pragma unroll
            for (int d = 0; d < 64; ++d) s += q[d] * ks[j][d];
            if (s > m) { const float f = exp2f(m - s); l *= f;
#pragma unroll
                for (int d = 0; d < 128; ++d) o[d] *= f;
                m = s; }
            const float p = exp2f(s - m); l += p;
#pragma unroll
            for (int d = 0; d < 128; ++d) o[d] += p * vs[j][d];
        }
    }
    float* O = c ? O2 : O1; const float il = 1.f / l;
#pragma unroll
    for (int d = 0; d < 128; ++d) O[row * 512 + h * 128 + d] = o[d] * il;
}

__global__ __launch_bounds__(256) void k_combine(const float* O1, const float* O2, const float* lq1, const float* lk1, const float* lq2, const float* lk2, const float* sg, bf16* amix) {
    const int row = blockIdx.x * 4 + (threadIdx.x >> 6), lane = threadIdx.x & 63;
    const float lam = __expf(wave_sum(lq1[lane] * lk1[lane])) - __expf(wave_sum(lq2[lane] * lk2[lane])) + LAMBDA_INIT;
    float d[8]; float ss = 0.f;
#pragma unroll
    for (int e = 0; e < 8; ++e) { const size_t i = (size_t)row * 512 + lane * 8 + e; d[e] = O1[i] - lam * O2[i]; ss += d[e] * d[e]; }
    ss += __shfl_xor(ss, 1); ss += __shfl_xor(ss, 2); ss += __shfl_xor(ss, 4); ss += __shfl_xor(ss, 8);
    const float r = rsqrtf(ss * (1.f / 128.f) + SUBLN_EPS) * (1.f - LAMBDA_INIT);
#pragma unroll
    for (int e = 0; e < 8; ++e) { const int col = lane * 8 + e; amix[(size_t)row * DM + 512 + col] = (bf16)f2bf(d[e] * r * sg[col & 127]); }
}

__global__ __launch_bounds__(256) void k_sgu_ln(const bf16* VS, const float* g, const float* bsh, float* vn) {
    const int row = blockIdx.x * 4 + (threadIdx.x >> 6), lane = threadIdx.x & 63;
    float v[8]; float s = 0.f;
#pragma unroll
    for (int e = 0; e < 8; ++e) { v[e] = bf2f(VS[(size_t)row * 512 + lane * 8 + e]); s += v[e]; }
    const float mu = wave_sum(s) * (1.f / 512.f); float q = 0.f;
#pragma unroll
    for (int e = 0; e < 8; ++e) { v[e] -= mu; q += v[e] * v[e]; }
    const float r = rsqrtf(wave_sum(q) * (1.f / 512.f) + LN_EPS);
#pragma unroll
    for (int e = 0; e < 8; ++e) { const int c = lane * 8 + e; vn[(size_t)row * 512 + c] = v[e] * r * g[c] + bsh[c]; }
}
__global__ __launch_bounds__(128) void k_sgu_mix(const float* vn, const bf16* U, const float* Ws, const float* bs, bf16* amix) {
    const int ch = blockIdx.x, g = blockIdx.y, b = blockIdx.z, d = threadIdx.x;
    const size_t row0 = (size_t)b * SEQ + ch * 128;
    float v[128];
#pragma unroll
    for (int s = 0; s < 128; ++s) v[s] = vn[(row0 + s) * 512 + g * 128 + d];
    for (int t = 0; t < 128; ++t) {
        const float* w = Ws + (size_t)(g * 128 + t) * 128;
        float acc = 0.f;
#pragma unroll
        for (int s = 0; s < 128; ++s) acc += (s <= t ? w[s] : 0.f) * v[s];
        const float mixed = acc + bs[g * 128 + t];
        amix[(row0 + t) * DM + g * 128 + d] = (bf16)f2bf(bf2f(U[(row0 + t) * 512 + g * 128 + d]) * mixed);
    }
}

extern "C" void kernel_launch(void* const* d_in, const int* in_sizes, int n_in, void* d_out, int out_size, void* d_ws, size_t ws_size, hipStream_t stream) {
    if (n_in != 24 || in_sizes[0] != M * DM || out_size != M * DM || ws_size < WS_END) { fprintf(stderr, "kernel_launch: unexpected shapes (n_in %d, ws %zu)\n", n_in, ws_size); return; }
    const float* x = (const float*)d_in[0];
    const float *f1pre = (const float*)d_in[1], *f1g = (const float*)d_in[2], *f1u = (const float*)d_in[3], *f1d = (const float*)d_in[4], *f1post = (const float*)d_in[5];
    const float *mixpre = (const float*)d_in[6], *win = (const float*)d_in[7], *lng = (const float*)d_in[8], *lnb = (const float*)d_in[9], *sws = (const float*)d_in[10], *sbs = (const float*)d_in[11];
    const float *lq1 = (const float*)d_in[12], *lk1 = (const float*)d_in[13], *lq2 = (const float*)d_in[14], *lk2 = (const float*)d_in[15], *subg = (const float*)d_in[16];
    const float *wout = (const float*)d_in[17], *mixpost = (const float*)d_in[18], *f2pre = (const float*)d_in[19], *f2g = (const float*)d_in[20], *f2u = (const float*)d_in[21], *f2d = (const float*)d_in[22], *f2post = (const float*)d_in[23];
    unsigned char* ws = (unsigned char*)d_ws; float* out = (float*)d_out;
    float* rope = (float*)(ws + WS_ROPE); bf16* XN = (bf16*)(ws + WS_XN); bf16* ACT = (bf16*)(ws + WS_ACT);
    bf16 *U = (bf16*)(ws + WS_U), *VS = (bf16*)(ws + WS_VS), *Q = (bf16*)(ws + WS_Q), *Kb = (bf16*)(ws + WS_K), *V = (bf16*)(ws + WS_V);
    bf16* AMIX = (bf16*)(ws + WS_AMIX); float* TMP = (float*)(ws + WS_STASH); float* O1 = TMP; float* O2 = TMP + (size_t)M * 512;
    float* VN = (float*)(ws + WS_XN);

    k_rope_table<<<SEQ * 32 / 256, 256, 0, stream>>>(rope);
    k_rms_bf16<<<M / 4, 256, 0, stream>>>(x, f1pre, XN);
    k_gemm_naive<EpiSwiglu, true><<<dim3(DFF / 64, M / 64), 256, 0, stream>>>(XN, f1g, f1u, EpiSwiglu{ACT}, DM, DFF, DM, 0);
    k_gemm_naive<EpiF32, false><<<dim3(DM / 64, M / 64), 256, 0, stream>>>(ACT, f1d, nullptr, EpiF32{TMP, DM, 0}, DFF, DM, DFF, 0);
    k_rowpost<<<M / 4, 256, 0, stream>>>(TMP, x, f1post, out, mixpre, XN, 0.5f, 0);
    k_gemm_naive<EpiWin, false><<<dim3(INC / 64, M / 64), 256, 0, stream>>>(XN, win, nullptr, EpiWin{U, VS, V, TMP}, DM, INC, DM, 0);
    k_rope_apply<<<(unsigned)(((size_t)M * 16 * 32) / 256), 256, 0, stream>>>(TMP, rope, Q, Kb);
    k_attn_naive<<<dim3(SEQ / 256, NH * 2, BATCH), 256, 0, stream>>>(Q, Kb, V, O1, O2);
    k_combine<<<M / 4, 256, 0, stream>>>(O1, O2, lq1, lk1, lq2, lk2, subg, AMIX);
    k_sgu_ln<<<M / 4, 256, 0, stream>>>(VS, lng, lnb, VN);
    k_sgu_mix<<<dim3(SEQ / CHUNK, NGRP, BATCH), 128, 0, stream>>>(VN, U, sws, sbs, AMIX);
    k_gemm_naive<EpiF32, false><<<dim3(DM / 64, M / 64), 256, 0, stream>>>(AMIX, wout, nullptr, EpiF32{TMP, DM, 0}, DM, DM, DM, 0);
    k_rowpost<<<M / 4, 256, 0, stream>>>(TMP, out, mixpost, out, f2pre, XN, 1.0f, 0);
    k_gemm_naive<EpiSwiglu, true><<<dim3(DFF / 64, M / 64), 256, 0, stream>>>(XN, f2g, f2u, EpiSwiglu{ACT}, DM, DFF, DM, 0);
    k_gemm_naive<EpiF32, false><<<dim3(DM / 64, M / 64), 256, 0, stream>>>(ACT, f2d, nullptr, EpiF32{TMP, DM, 0}, DFF, DM, DFF, 0);
    k_rowpost<<<M / 4, 256, 0, stream>>>(TMP, out, f2post, out, nullptr, nullptr, 0.5f, 0);
}
```
